# Optimizing an MI355X kernel written in HIP

```python
import math
import jax, jax.numpy as jnp
from jax import lax
import numpy as np

D_MODEL = 2048
BATCH = 4
SEQ = 2048
DEPTH = 1
DEC_BATCH = 128
DEC_SEQ = 4
PAST_LEN = 16384
PAGE_SIZE = 128

MIX_WIDTH = D_MODEL
C_CONV = MIX_WIDTH // 2
C_POOL = MIX_WIDTH - C_CONV
CONV_HEADS = 8
CONV_HEAD_DIM = C_CONV // CONV_HEADS
CONV_WIDTH = 31
POOL_WINDOWS = (2, 4, 8, 16)
N_POOL_GROUPS = len(POOL_WINDOWS)
POOL_GROUP = C_POOL // N_POOL_GROUPS
MAX_WINDOW = max(POOL_WINDOWS)
D_FF = 4 * D_MODEL
N_META = 16
EPS = 1e-6

kernel_name = "hymba_conformer_conv_multiscale_pool_decoder_step"


def rmsnorm(x, g):
    xf = x.astype(jnp.float32)
    y = xf * lax.rsqrt(jnp.mean(xf * xf, axis=-1, keepdims=True) + EPS)
    return (y * g.astype(jnp.float32)).astype(x.dtype)


def head_layernorm(u, g, b):
    n, t, c = u.shape
    uf = u.astype(jnp.float32).reshape(n, t, CONV_HEADS, CONV_HEAD_DIM)
    mu = jnp.mean(uf, axis=-1, keepdims=True)
    var = jnp.mean(jnp.square(uf - mu), axis=-1, keepdims=True)
    y = ((uf - mu) * lax.rsqrt(var + EPS)).reshape(n, t, c)
    return (y * g.astype(jnp.float32) + b.astype(jnp.float32)).astype(u.dtype)


def depthwise_causal_conv(u_full, w_dw, b_dw):
    c = u_full.shape[-1]
    y = lax.conv_general_dilated(
        u_full, w_dw[:, None, :].astype(u_full.dtype), window_strides=(1,), padding='VALID',
        dimension_numbers=('NWC', 'WIO', 'NWC'), feature_group_count=c)
    return y + b_dw.astype(y.dtype)


def multiscale_pool(hist, xb, pos0, w_pool, pool_scale):
    L = hist.shape[1]
    T = xb.shape[1]
    z = jnp.concatenate([hist, xb], axis=1).astype(jnp.float32)
    csum = jnp.concatenate([jnp.zeros_like(z[:, :1]), jnp.cumsum(z, axis=1)], axis=1)
    pos = jnp.arange(T, dtype=jnp.float32) + pos0
    xf = xb.astype(jnp.float32)
    outs = []
    for gi, w in enumerate(POOL_WINDOWS):
        sl = slice(gi * POOL_GROUP, (gi + 1) * POOL_GROUP)
        s = csum[:, L + 1:L + 1 + T, sl] - csum[:, L + 1 - w:L + 1 - w + T, sl]
        cnt = jnp.minimum(jnp.float32(w), pos + 1.0)
        d = s / cnt[None, :, None] - xf[..., sl]
        outs.append(jnp.einsum('btc,cd->btd', d, w_pool[gi].astype(jnp.float32)))
    y = jnp.concatenate(outs, axis=-1) * pool_scale.astype(jnp.float32)
    return y.astype(xb.dtype)


def mixer(h, conv_hist, pool_hist, pos0, w_in, w_dw, b_dw, ln_g, ln_b, w_pool, pool_scale, w_out):
    proj = jnp.einsum('btd,de->bte', h, w_in)
    a = proj[..., :C_CONV]
    gate = proj[..., C_CONV:2 * C_CONV]
    xb = proj[..., 2 * C_CONV:]
    u = a * jax.nn.sigmoid(gate)
    u_full = jnp.concatenate([conv_hist.astype(u.dtype), u], axis=1)
    c = depthwise_causal_conv(u_full, w_dw, b_dw)
    c = jax.nn.silu(head_layernorm(c, ln_g, ln_b))
    p = multiscale_pool(pool_hist.astype(xb.dtype), xb, pos0, w_pool, pool_scale)
    y = jnp.einsum('bte,ed->btd', jnp.concatenate([c, p], axis=-1), w_out)
    new_conv = u_full[:, -(CONV_WIDTH - 1):]
    new_pool = jnp.concatenate([pool_hist.astype(xb.dtype), xb], axis=1)[:, -(MAX_WINDOW - 1):]
    return y, new_conv, new_pool


def sq_relu_mlp(h, w_up, w_down):
    a = jax.nn.relu(jnp.einsum('btd,df->btf', h, w_up))
    return jnp.einsum('btf,fd->btd', a * a, w_down)


def setup_inputs(seed: int = 0) -> dict:
    key = jax.random.key(seed)
    ks = jax.random.split(key, 20)
    f32 = jnp.float32
    n = lambda k, s, sc: jax.random.normal(k, s, f32) * sc
    return {
        "x_prompt": n(ks[0], (BATCH, SEQ, D_MODEL), 1.0),
        "x_sample": n(ks[1], (DEC_BATCH, DEC_SEQ, D_MODEL), 1.0),
        "state_conv": n(ks[2], (DEPTH, DEC_BATCH, CONV_WIDTH - 1, C_CONV), 0.5),
        "state_pool": n(ks[3], (DEPTH, DEC_BATCH, MAX_WINDOW - 1, C_POOL), 1.0),
        "meta_tokens": n(ks[4], (N_META, D_MODEL), 1.0),
        "norm_mix_g": 1.0 + n(ks[5], (DEPTH, D_MODEL), 0.02),
        "w_in": n(ks[6], (DEPTH, D_MODEL, 2 * C_CONV + C_POOL), D_MODEL ** -0.5),
        "w_dw": n(ks[7], (DEPTH, CONV_WIDTH, C_CONV), CONV_WIDTH ** -0.5),
        "b_dw": n(ks[8], (DEPTH, C_CONV), 0.02),
        "conv_ln_g": 1.0 + n(ks[9], (DEPTH, C_CONV), 0.02),
        "conv_ln_b": n(ks[10], (DEPTH, C_CONV), 0.02),
        "w_pool": n(ks[11], (DEPTH, N_POOL_GROUPS, POOL_GROUP, POOL_GROUP), POOL_GROUP ** -0.5),
        "pool_scale": 1.0 + n(ks[12], (DEPTH, C_POOL), 0.1),
        "w_out": n(ks[13], (DEPTH, C_CONV + C_POOL, D_MODEL), (C_CONV + C_POOL) ** -0.5),
        "norm_ffn_g": 1.0 + n(ks[14], (DEPTH, D_MODEL), 0.02),
        "w_up": n(ks[15], (DEPTH, D_MODEL, D_FF), D_MODEL ** -0.5),
        "w_down": n(ks[16], (DEPTH, D_FF, D_MODEL), D_FF ** -0.5),
        "final_norm_g": 1.0 + n(ks[17], (D_MODEL,), 0.02),
    }


def reference(x_prompt, x_sample, state_conv, state_pool, meta_tokens, norm_mix_g, w_in, w_dw, b_dw,
              conv_ln_g, conv_ln_b, w_pool, pool_scale, w_out, norm_ffn_g, w_up, w_down, final_norm_g):
    meta = jnp.broadcast_to(meta_tokens.astype(x_prompt.dtype)[None], (x_prompt.shape[0], N_META, D_MODEL))
    xp = jnp.concatenate([meta, x_prompt], axis=1)
    xs = x_sample
    nb = xp.shape[0]
    zero_conv = jnp.zeros((nb, CONV_WIDTH - 1, C_CONV), xp.dtype)
    zero_pool = jnp.zeros((nb, MAX_WINDOW - 1, C_POOL), xp.dtype)
    conv_p, pool_p, conv_s, pool_s = [], [], [], []
    for l in range(DEPTH):
        wl = (w_in[l], w_dw[l], b_dw[l], conv_ln_g[l], conv_ln_b[l], w_pool[l], pool_scale[l], w_out[l])
        yp, cp, pp = mixer(rmsnorm(xp, norm_mix_g[l]), zero_conv, zero_pool, 0, *wl)
        xp = xp + yp
        xp = xp + sq_relu_mlp(rmsnorm(xp, norm_ffn_g[l]), w_up[l], w_down[l])
        ys, cs, ps = mixer(rmsnorm(xs, norm_mix_g[l]), state_conv[l], state_pool[l], PAST_LEN, *wl)
        xs = xs + ys
        xs = xs + sq_relu_mlp(rmsnorm(xs, norm_ffn_g[l]), w_up[l], w_down[l])
        conv_p.append(cp); pool_p.append(pp); conv_s.append(cs); pool_s.append(ps)
    y_prompt = rmsnorm(xp, final_norm_g)[:, N_META:]
    y_sample = rmsnorm(xs, final_norm_g)
    new_conv_prompt = jnp.stack(conv_p, axis=0)
    new_pool_prompt = jnp.stack(pool_p, axis=0)
    new_conv_sample = jnp.stack(conv_s, axis=0)
    new_pool_sample = jnp.stack(pool_s, axis=0)
    return (y_prompt, y_sample, new_conv_prompt, new_pool_prompt, new_conv_sample, new_pool_sample)
```

```cpp
#include <hip/hip_runtime.h>
#include <cstdio>
#include <cstdint>
namespace pg8 {
#define PG8_LAS __attribute__((address_space(3)))
typedef unsigned short bf16_t;
typedef short bf16x8 __attribute__((ext_vector_type(8)));
typedef float f32x4 __attribute__((ext_vector_type(4)));
typedef unsigned u32x4 __attribute__((ext_vector_type(4)));
constexpr int BM = 256, BK = 64, HALF = 128, HTB = HALF * BK * 2  , STAGE_BYTES = 8 * HTB, NXCD = 8, WGM = 8;

__host__ __device__ __forceinline__ int lds_byte(int r, int c) { const int st = (r >> 4) * 2 + (c >> 5), rr = r & 15, cc = c & 31, ob = rr * 64 + cc * 2; return st * 1024 + (ob ^ (((ob >> 9) & 1) << 5)); }
__host__ __device__ __forceinline__ void stage_rc(int b, int& R, int& C) { const int st = b / 1024, sb = b % 1024, swz = sb ^ (((sb >> 9) & 1) << 5); R = (st >> 1) * 16 + swz / 64; C = (st & 1) * 32 + (swz % 64) / 2; }
__host__ __device__ __forceinline__ int perm32(int rho) { const int n = rho >> 4, i = rho & 15; return 8 * (i >> 2) + 4 * n + (i & 3); }

struct Unit { int pm, pn; };
struct Gemm { const bf16_t* A; const bf16_t* Bt; int M, N, K; };

struct StaticOrder {
    int nM, nN, nwg, G, c;
    __host__ __device__ void init(int M, int N, int G_, int c_) { nM = M / BM; nN = N / BM; nwg = nM * nN; G = G_; c = c_; }
    __host__ __device__ bool next(int i, Unit& u) const {
        const long L = (long)i * G + c; if (L >= nwg) return false;
        int wgid = (int)L; { const int q = nwg / NXCD, r = nwg % NXCD, xcd = wgid % NXCD, off = wgid / NXCD; wgid = (xcd < r ? xcd * (q + 1) : r * (q + 1) + (xcd - r) * q) + off; }
        const int nig = WGM * nN, gid = wgid / nig, fm = gid * WGM, gsz = (nM - fm) < WGM ? (nM - fm) : WGM;
        u.pm = fm + ((wgid % nig) % gsz); u.pn = (wgid % nig) / gsz; return true;
    }
    __device__ __forceinline__ void a_ready(const Unit&) const {}
    __device__ __forceinline__ void done(const Unit&) const {}
};

template <class Epi, class Sched, bool ALIGN_EPI = false, bool SP2 = false>
__device__ __forceinline__ void gemm_phase(PG8_LAS unsigned char* lds, const Gemm g, const Sched& S, const Epi& E) {
    const int tid = threadIdx.x, wid = __builtin_amdgcn_readfirstlane(tid >> 6), lane = tid & 63, wr = wid >> 2, wc = wid & 3, fr = lane & 15, fq = lane >> 4;
    const int K = g.K, nt = K / BK;
    unsigned voffA[2], voffB[2];
#pragma unroll
    for (int i = 0; i < 2; ++i) { int R, C; stage_rc(tid * 16 + i * 8192, R, C); const int Rb = Epi::PERM ? ((R & ~31) + perm32(R & 31)) : R;
        voffA[i] = (unsigned)(R * K + C) * 2u; voffB[i] = (unsigned)(Rb * K + C) * 2u; }
    const size_t kstep = (size_t)(BK * 2);
    const size_t hstep = (size_t)HALF * K * 2;
    const size_t tstep = 2 * hstep;
    const unsigned ldsw = (unsigned)wid * 1024u;
    const int aoff = lds_byte(wr * 64 + fr, fq * 8), boff = lds_byte(wc * 32 + fr, fq * 8);
#define PG8_SA(b, h) (((b) * 2 + (h)) * HTB)
#define PG8_SB(b, h) ((4 + (b) * 2 + (h)) * HTB)
#define PG8_STAGE(bufoff, gbase, voff) do { _Pragma("unroll") for (int _i = 0; _i < 2; ++_i) \
        __builtin_amdgcn_global_load_lds((const unsigned*)((const char*)(gbase) + (voff)[_i]), (PG8_LAS unsigned*)(lds + (bufoff) + ldsw + _i * 8192), 16, 0, 0); } while (0)
#define PG8_LDA(dst, b, h) do { _Pragma("unroll") for (int m = 0; m < 4; ++m) _Pragma("unroll") for (int k = 0; k < 2; ++k) dst[m][k] = *(const PG8_LAS bf16x8*)(lds + PG8_SA(b, h) + aoff + m * 2048 + k * 1024); } while (0)
#define PG8_LDB(dst, b, h) do { _Pragma("unroll") for (int n = 0; n < 2; ++n) _Pragma("unroll") for (int k = 0; k < 2; ++k) dst[n][k] = *(const PG8_LAS bf16x8*)(lds + PG8_SB(b, h) + boff + n * 2048 + k * 1024); } while (0)
#define PG8_MMA(ai, bj, At, Bt) do { __builtin_amdgcn_s_setprio(1); _Pragma("unroll") for (int m = 0; m < 4; ++m) _Pragma("unroll") for (int n = 0; n < 2; ++n) _Pragma("unroll") for (int k = 0; k < 2; ++k) \
        acc[ai][bj][m][n] = __builtin_amdgcn_mfma_f32_16x16x32_bf16(Bt[n][k], At[m][k], acc[ai][bj][m][n], 0, 0, 0); __builtin_amdgcn_s_setprio(0); } while (0)
#define PG8_WAIT_V(n) asm volatile("s_waitcnt vmcnt(" #n ")" ::: "memory")
#define PG8_WAIT_L(n) asm volatile("s_waitcnt lgkmcnt(" #n ")" ::: "memory")
#define PG8_BAR __builtin_amdgcn_s_barrier()
#define PG8_SCHED __builtin_amdgcn_sched_barrier(0)
    Unit cur, nxt; int ui = 0;
    if (!S.next(0, cur)) return;
    f32x4 acc[2][2][4][2];
#pragma unroll
    for (int a = 0; a < 2; ++a)
#pragma unroll
        for (int b = 0; b < 2; ++b)
#pragma unroll
            for (int m = 0; m < 4; ++m)
#pragma unroll
                for (int n = 0; n < 2; ++n) acc[a][b][m][n] = (f32x4){0.f, 0.f, 0.f, 0.f};
    bf16x8 At[4][2], B0[2][2], B1[2][2];
    const char* cA = (const char*)g.A + (size_t)cur.pm * tstep; const char* cB = (const char*)g.Bt + (size_t)cur.pn * tstep;
    S.a_ready(cur);
    if constexpr (SP2) {
        PG8_STAGE(PG8_SB(0, 0), cB, voffB); PG8_STAGE(PG8_SB(0, 1), cB + hstep, voffB); PG8_STAGE(PG8_SA(0, 0), cA, voffA); PG8_STAGE(PG8_SA(0, 1), cA + hstep, voffA);
        if (wr == 1) PG8_BAR;
        PG8_WAIT_V(2); PG8_BAR;
        PG8_STAGE(PG8_SB(1, 0), cB + kstep, voffB); PG8_STAGE(PG8_SA(1, 0), cA + kstep, voffA); PG8_STAGE(PG8_SB(1, 1), cB + hstep + kstep, voffB);
        PG8_WAIT_V(6); PG8_BAR;
    } else {
        PG8_STAGE(PG8_SB(0, 0), cB, voffB); PG8_STAGE(PG8_SA(0, 0), cA, voffA); PG8_STAGE(PG8_SB(0, 1), cB + hstep, voffB); PG8_STAGE(PG8_SA(0, 1), cA + hstep, voffA);
        if (wr == 1) PG8_BAR;
        PG8_WAIT_V(4); PG8_BAR;
        PG8_STAGE(PG8_SB(1, 0), cB + kstep, voffB); PG8_STAGE(PG8_SA(1, 0), cA + kstep, voffA); PG8_STAGE(PG8_SB(1, 1), cB + hstep + kstep, voffB);
        PG8_WAIT_V(6); PG8_BAR;
    }
    for (;;) {
        const bool has_next = S.next(ui + 1, nxt);
        const char* nA = has_next ? (const char*)g.A + (size_t)nxt.pm * tstep : cA; const char* nB = has_next ? (const char*)g.Bt + (size_t)nxt.pn * tstep : cB;
        for (int t = 0; t < nt; t += 2) {
            const bool last = (t == nt - 2);
            const char* a1 = cA + (size_t)(t + 1) * kstep;
            const char* a2 = last ? nA : cA + (size_t)(t + 2) * kstep; const char* b2 = last ? nB : cB + (size_t)(t + 2) * kstep;
            const char* a3 = a2 + kstep; const char* b3 = b2 + kstep;
            if (last && has_next) S.a_ready(nxt);
            if constexpr (SP2) {
            PG8_LDB(B0, 0, 0); PG8_LDB(B1, 0, 1); PG8_SCHED; PG8_LDA(At, 0, 0); PG8_STAGE(PG8_SA(1, 1), a1 + hstep, voffA);
            PG8_WAIT_V(8); PG8_WAIT_L(0); PG8_BAR; PG8_MMA(0, 0, At, B0); PG8_MMA(0, 1, At, B1); PG8_BAR; PG8_SCHED;
            PG8_LDA(At, 0, 1); PG8_STAGE(PG8_SB(0, 0), b2, voffB); PG8_STAGE(PG8_SB(0, 1), b2 + hstep, voffB); PG8_STAGE(PG8_SA(0, 0), a2, voffA);
            PG8_WAIT_V(8); PG8_WAIT_L(0); PG8_BAR; PG8_MMA(1, 0, At, B0); PG8_MMA(1, 1, At, B1); PG8_BAR; PG8_SCHED;
            PG8_LDB(B0, 1, 0); PG8_LDB(B1, 1, 1); PG8_SCHED; PG8_LDA(At, 1, 0); PG8_STAGE(PG8_SA(0, 1), a2 + hstep, voffA);
            PG8_WAIT_V(8); PG8_WAIT_L(0); PG8_BAR; PG8_MMA(0, 0, At, B0); PG8_MMA(0, 1, At, B1); PG8_BAR; PG8_SCHED;
            PG8_LDA(At, 1, 1); PG8_STAGE(PG8_SB(1, 0), b3, voffB); PG8_STAGE(PG8_SB(1, 1), b3 + hstep, voffB); PG8_STAGE(PG8_SA(1, 0), a3, voffA);
            PG8_WAIT_V(8); PG8_WAIT_L(0); PG8_BAR; PG8_MMA(1, 0, At, B0); PG8_MMA(1, 1, At, B1); PG8_BAR; PG8_SCHED;
            } else {
            PG8_LDB(B0, 0, 0); PG8_SCHED; PG8_LDA(At, 0, 0); PG8_STAGE(PG8_SA(1, 1), a1 + hstep, voffA);
            PG8_WAIT_L(8); PG8_BAR; PG8_WAIT_L(0); PG8_MMA(0, 0, At, B0); PG8_BAR; PG8_SCHED;
            PG8_LDB(B1, 0, 1); PG8_STAGE(PG8_SB(0, 0), b2, voffB);
            PG8_BAR; PG8_WAIT_L(0); PG8_MMA(0, 1, At, B1); PG8_BAR;
            PG8_LDA(At, 0, 1); PG8_STAGE(PG8_SA(0, 0), a2, voffA);
            PG8_BAR; PG8_WAIT_L(0); PG8_MMA(1, 0, At, B0); PG8_BAR; PG8_SCHED;
            PG8_STAGE(PG8_SB(0, 1), b2 + hstep, voffB);
            PG8_WAIT_V(6); PG8_BAR; PG8_MMA(1, 1, At, B1); PG8_BAR;
            PG8_LDB(B0, 1, 0); PG8_SCHED; PG8_LDA(At, 1, 0); PG8_STAGE(PG8_SA(0, 1), a2 + hstep, voffA);
            PG8_WAIT_L(8); PG8_BAR; PG8_WAIT_L(0); PG8_MMA(0, 0, At, B0); PG8_BAR; PG8_SCHED;
            PG8_LDB(B1, 1, 1); PG8_STAGE(PG8_SB(1, 0), b3, voffB);
            PG8_BAR; PG8_WAIT_L(0); PG8_MMA(0, 1, At, B1); PG8_BAR;
            PG8_LDA(At, 1, 1); PG8_STAGE(PG8_SA(1, 0), a3, voffA);
            PG8_BAR; PG8_WAIT_L(0); PG8_MMA(1, 0, At, B0); PG8_BAR; PG8_SCHED;
            PG8_STAGE(PG8_SB(1, 1), b3 + hstep, voffB);
            PG8_WAIT_V(6); PG8_BAR; PG8_MMA(1, 1, At, B1); PG8_BAR;
            }
        }
        if constexpr (ALIGN_EPI) { if (wr == 0) PG8_BAR; }
        if constexpr (!Epi::AFTER_DRAIN) { E(acc, cur, wr, wc, fr, fq); S.done(cur); }
        if (!has_next) break;
#pragma unroll
        for (int a = 0; a < 2; ++a)
#pragma unroll
            for (int b = 0; b < 2; ++b)
#pragma unroll
                for (int m = 0; m < 4; ++m)
#pragma unroll
                    for (int n = 0; n < 2; ++n) acc[a][b][m][n] = (f32x4){0.f, 0.f, 0.f, 0.f};
        cur = nxt; cA = nA; cB = nB; ++ui;
        if constexpr (ALIGN_EPI) { if (wr == 1) PG8_BAR; }
    }
    PG8_WAIT_V(0);
    if constexpr (!ALIGN_EPI) { if (wr == 0) PG8_BAR; }
    PG8_BAR;
    if constexpr (Epi::AFTER_DRAIN) { E.fused(acc, cur, wr, wc, fr, fq, lds, wid, lane); S.done(cur); }
#undef PG8_SA
#undef PG8_SB
#undef PG8_STAGE
#undef PG8_LDA
#undef PG8_LDB
#undef PG8_MMA
#undef PG8_WAIT_V
#undef PG8_WAIT_L
#undef PG8_BAR
#undef PG8_SCHED
}
}

constexpr int DM = 2048, NBATCH = 4, SEQ = 2048, DECB = 128, DECS = 4, CCONV = 1024, CPOOL = 1024, DFF = 8192, NMETA = 16, CONVW = 31, MAXW = 16;
constexpr int MPROMPT = NBATCH * SEQ;
constexpr int MROWS = MPROMPT + DECB * DECS;
constexpr int HROWS = MROWS + NMETA;
constexpr int NIN = 2 * CCONV + CPOOL;
constexpr float EPS = 1e-6f;
static_assert(MROWS % 256 == 0, "row tiles");

constexpr size_t MiB = 1u << 20;
constexpr size_t WS_CTL = 0, CTL_ZERO_BYTES = 1 * MiB;
constexpr size_t WS_WUP = 1 * MiB;
constexpr size_t WS_WDN = 33 * MiB;
constexpr size_t WS_X1B = 65 * MiB;
constexpr size_t WS_ACT = 99 * MiB;
constexpr size_t WS_WIN = 99 * MiB;
constexpr size_t WS_WOUT = 111 * MiB;
constexpr size_t WS_H = 119 * MiB;
constexpr size_t WS_U = 154 * MiB;
constexpr size_t WS_XB = 172 * MiB;
constexpr size_t WS_CP = 190 * MiB;
constexpr size_t WS_WPOOL = 235 * MiB;
constexpr size_t WS_END = 236 * MiB;
static_assert(WS_ACT + (size_t)MROWS * DFF * 2 <= WS_WPOOL && WS_CP + (size_t)MROWS * DM * 2 <= WS_WPOOL && WS_H + (size_t)HROWS * DM * 2 <= WS_U && WS_U + (size_t)HROWS * CCONV * 2 <= WS_XB && WS_XB + (size_t)HROWS * CPOOL * 2 <= WS_CP, "ws map");
constexpr int CW_BAR = 4096;
constexpr int CW_SSQ1 = 16384, CW_SSQ2 = 32768;

constexpr size_t OUT_Y = 0;
constexpr size_t OUT_NCP = (size_t)MROWS * DM;
constexpr size_t OUT_NPP = OUT_NCP + (size_t)NBATCH * 30 * CCONV;
constexpr size_t OUT_NCS = OUT_NPP + (size_t)NBATCH * 15 * CPOOL;
constexpr size_t OUT_NPS = OUT_NCS + (size_t)DECB * 30 * CCONV;
constexpr size_t OUT_END = OUT_NPS + (size_t)DECB * 15 * CPOOL;

constexpr int RING_OFF = 0, RING_BYTES = 131072;
constexpr int LDSCTL_OFF = RING_BYTES;
constexpr int LDS_BYTES = 147456;

#define GAS __attribute__((address_space(1)))
#define LAS __attribute__((address_space(3)))
typedef unsigned short bf16;
typedef unsigned v4u __attribute__((ext_vector_type(4)));
typedef unsigned v2u __attribute__((ext_vector_type(2)));
typedef float f32x4 __attribute__((ext_vector_type(4)));
typedef float f32x2 __attribute__((ext_vector_type(2)));
typedef short bf16x8 __attribute__((ext_vector_type(8)));
#define LDS_WAIT() asm volatile("s_waitcnt lgkmcnt(0)" ::: "memory")
#define VM_WAIT() asm volatile("s_waitcnt vmcnt(0)" ::: "memory")
__device__ __forceinline__ unsigned f2bf(float f) { unsigned u = __builtin_bit_cast(unsigned, f); return (u + 0x7fffu + ((u >> 16) & 1u)) >> 16; }
__device__ __forceinline__ unsigned pk2(float lo, float hi) { return f2bf(lo) | (f2bf(hi) << 16); }
__device__ __forceinline__ float bflo(unsigned v) { return __builtin_bit_cast(float, v << 16); }
__device__ __forceinline__ float bfhi(unsigned v) { return __builtin_bit_cast(float, v & 0xffff0000u); }
__device__ __forceinline__ float sigmoidf_fast(float x) { return __builtin_amdgcn_rcpf(1.0f + __expf(-x)); }
__device__ __forceinline__ float wave_sum(float v) {
#pragma unroll
    for (int o = 1; o < 64; o <<= 1) v += __shfl_xor(v, o);
    return v;
}

#define XB_TMO      128
#define XB_XCNT(j)  (256  + 64 * (j))
#define XB_XSUB(j)  (1280 + 64 * (j))
#define XB_XGEN(j)  (2304 + 64 * (j))
#define XB_TOP      3328
#define XB_TOPGEN   3392
#define XCD_BAR_WORDS 3456
#define XB_SPIN_CAP (1u << 18)
__device__ __forceinline__ unsigned xb_ld(unsigned* p)              { return __hip_atomic_load(p, __ATOMIC_RELAXED, __HIP_MEMORY_SCOPE_AGENT); }
__device__ __forceinline__ unsigned xb_add(unsigned* p, unsigned v) { return __hip_atomic_fetch_add(p, v, __ATOMIC_RELAXED, __HIP_MEMORY_SCOPE_AGENT); }
__device__ __forceinline__ unsigned xb_xcc_id() { return (unsigned)__builtin_amdgcn_s_getreg((3 << 11) | 20) & 0xFu; }
#define XB_SPIN(cond, bar) do { unsigned _sp = 0; while (cond) { __builtin_amdgcn_s_sleep(1); \
    if ((++_sp & 255u) == 0u) { if (xb_ld(&(bar)[XB_TMO])) break; if (_sp > XB_SPIN_CAP) { atomicAdd(&(bar)[XB_TMO], 1u); break; } } } } while (0)
struct XcdBarrier { unsigned* bar; unsigned x; volatile LAS unsigned* st; };
__device__ __forceinline__ XcdBarrier xcd_barrier_post(unsigned* bar, volatile LAS unsigned* st) {
    XcdBarrier b; b.bar = bar; b.x = xb_xcc_id(); b.st = st;
    if (threadIdx.x == 0) (void)xb_add(&bar[XB_XCNT(b.x)], 1u);
    return b;
}
__device__ __forceinline__ void xcd_barrier_complete(unsigned* bar, unsigned x, unsigned& nloc, unsigned& nx) {
    const unsigned G = gridDim.x * gridDim.y * gridDim.z;
    unsigned sum, cnt, mine, sp = 0u;
    for (;;) {
        sum = 0u; cnt = 0u; mine = 0u;
#pragma unroll
        for (unsigned j = 0; j < 16; ++j) { const unsigned c = xb_ld(&bar[XB_XCNT(j)]); sum += c; cnt += (c > 0u) ? 1u : 0u; mine = (j == x) ? c : mine; }
        if (sum == G) break;
        __builtin_amdgcn_s_sleep(1);
        if ((++sp & 255u) == 0u) { if (xb_ld(&bar[XB_TMO])) break; if (sp > XB_SPIN_CAP) { atomicAdd(&bar[XB_TMO], 1u); break; } }
    }
    nloc = mine > 0u ? mine : 1u; nx = cnt > 0u ? cnt : 1u;
}
__device__ __forceinline__ void xcd_barrier(const XcdBarrier& b) {
    asm volatile("s_waitcnt vmcnt(0)" ::: "memory");
    __syncthreads();
    if (threadIdx.x == 0) {
        unsigned* bar = b.bar;
        __builtin_amdgcn_s_waitcnt(0);
        unsigned nloc = b.st[0], nx = b.st[1];
        if (nloc == 0u) { xcd_barrier_complete(bar, b.x, nloc, nx); b.st[0] = nloc; b.st[1] = nx; }
        const unsigned old = xb_add(&bar[XB_XSUB(b.x)], 1u);
        const unsigned gen = old / nloc;
        if (old + 1u == (gen + 1u) * nloc) {
            __builtin_amdgcn_fence(__ATOMIC_RELEASE, "agent");
            asm volatile("s_waitcnt vmcnt(0)" ::: "memory");
            const unsigned og = xb_add(&bar[XB_TOP], 1u);
            const unsigned tg = og / nx;
            if (og + 1u == (tg + 1u) * nx) xb_add(&bar[XB_TOPGEN], 1u);
            else XB_SPIN(xb_ld(&bar[XB_TOPGEN]) == tg, bar);
            __builtin_amdgcn_fence(__ATOMIC_ACQUIRE, "agent");
            xb_add(&bar[XB_XGEN(b.x)], 1u);
            asm volatile("s_waitcnt vmcnt(0)" ::: "memory");
        } else {
            XB_SPIN(xb_ld(&bar[XB_XGEN(b.x)]) == gen, bar);
            __builtin_amdgcn_fence(__ATOMIC_ACQUIRE, "agent");
            asm volatile("s_waitcnt vmcnt(0)" ::: "memory");
        }
    }
    __syncthreads();
}

using pg8::Unit;
__device__ __forceinline__ unsigned cvt_pk_bf16(float lo, float hi) { unsigned r; asm volatile("v_cvt_pk_bf16_f32 %0, %1, %2" : "=v"(r) : "v"(lo), "v"(hi)); return r; }
__device__ __forceinline__ v4u pack8(const f32x4 v0, const f32x4 v1) { v4u w; w.x = cvt_pk_bf16(v0[0], v0[1]); w.y = cvt_pk_bf16(v0[2], v0[3]); w.z = cvt_pk_bf16(v1[0], v1[1]); w.w = cvt_pk_bf16(v1[2], v1[3]); return w; }

struct EpiIn {
    static constexpr bool PERM = true, AFTER_DRAIN = false;
    bf16* U; bf16* XB;
    __device__ __forceinline__ void operator()(const f32x4 (&acc)[2][2][4][2], const Unit& u, int wr, int wc, int fr, int fq) const {
        const int row0 = u.pm * 256 + wr * 64 + fr;
        if (u.pn < 8) {
            const int col0 = u.pn * 128 + wc * 32 + 8 * fq;
#pragma unroll
            for (int ai = 0; ai < 2; ++ai)
#pragma unroll
                for (int m = 0; m < 4; ++m) {
                    f32x4 v0, v1;
#pragma unroll
                    for (int j = 0; j < 4; ++j) { v0[j] = acc[ai][0][m][0][j] * sigmoidf_fast(acc[ai][1][m][0][j]); v1[j] = acc[ai][0][m][1][j] * sigmoidf_fast(acc[ai][1][m][1][j]); }
                    *(v4u*)(U + (size_t)(row0 + ai * 128 + m * 16) * CCONV + col0) = pack8(v0, v1);
                }
        } else {
            const int col0 = (u.pn - 8) * 256 + wc * 32 + 8 * fq;
#pragma unroll
            for (int ai = 0; ai < 2; ++ai)
#pragma unroll
                for (int m = 0; m < 4; ++m) {
                    bf16* rowp = XB + (size_t)(row0 + ai * 128 + m * 16) * CPOOL + col0;
#pragma unroll
                    for (int bj = 0; bj < 2; ++bj) *(v4u*)(rowp + bj * 128) = pack8(acc[ai][bj][m][0], acc[ai][bj][m][1]);
                }
        }
    }
};
struct EpiOut {
    static constexpr bool PERM = true, AFTER_DRAIN = false;
    const float* xp; const float* xs; float* Y; bf16* X1B; float* ssq;
    __device__ __forceinline__ void operator()(const f32x4 (&acc)[2][2][4][2], const Unit& u, int wr, int wc, int fr, int fq) const {
        const int row0 = u.pm * 256 + wr * 64 + fr, col0 = u.pn * 256 + wc * 32 + 8 * fq;
#pragma unroll
        for (int ai = 0; ai < 2; ++ai)
#pragma unroll
            for (int m = 0; m < 4; ++m) {
                const int row = row0 + ai * 128 + m * 16;
                const float* xr = (row < MPROMPT ? xp + (size_t)row * DM : xs + (size_t)(row - MPROMPT) * DM) + col0;
                float* yr = Y + (size_t)row * DM + col0; bf16* br = X1B + (size_t)row * DM + col0;
                float s = 0.f;
#pragma unroll
                for (int bj = 0; bj < 2; ++bj) {
                    const f32x4 v0 = acc[ai][bj][m][0] + *(const f32x4*)(xr + bj * 128), v1 = acc[ai][bj][m][1] + *(const f32x4*)(xr + bj * 128 + 4);
                    *(f32x4*)(yr + bj * 128) = v0; *(f32x4*)(yr + bj * 128 + 4) = v1;
                    *(v4u*)(br + bj * 128) = pack8(v0, v1);
                    s += (v0[0] * v0[0] + v0[1] * v0[1]) + (v0[2] * v0[2] + v0[3] * v0[3]) + (v1[0] * v1[0] + v1[1] * v1[1]) + (v1[2] * v1[2] + v1[3] * v1[3]);
                }
                s += __shfl_xor(s, 16); s += __shfl_xor(s, 32);
                if (fq == 0) atomicAdd(ssq + row, s);
            }
    }
};
struct EpiUp {
    static constexpr bool PERM = true, AFTER_DRAIN = false;
    bf16* ACT; const float* ssq;
    __device__ __forceinline__ void operator()(const f32x4 (&acc)[2][2][4][2], const Unit& u, int wr, int wc, int fr, int fq) const {
        const int row0 = u.pm * 256 + wr * 64 + fr, col0 = u.pn * 256 + wc * 32 + 8 * fq;
#pragma unroll
        for (int ai = 0; ai < 2; ++ai)
#pragma unroll
            for (int m = 0; m < 4; ++m) {
                const int row = row0 + ai * 128 + m * 16;
                const float rstd = __builtin_amdgcn_rsqf(__builtin_nontemporal_load(ssq + row) * (1.0f / DM) + EPS);
                bf16* rowp = ACT + (size_t)row * DFF + col0;
#pragma unroll
                for (int bj = 0; bj < 2; ++bj) {
                    f32x4 v0, v1;
#pragma unroll
                    for (int j = 0; j < 4; ++j) { const float a = fmaxf(acc[ai][bj][m][0][j], 0.f) * rstd, b = fmaxf(acc[ai][bj][m][1][j], 0.f) * rstd; v0[j] = a * a; v1[j] = b * b; }
                    *(v4u*)(rowp + bj * 128) = pack8(v0, v1);
                }
            }
    }
};
struct EpiDown {
    static constexpr bool PERM = true, AFTER_DRAIN = false;
    float* Y; float* ssq;
    __device__ __forceinline__ void operator()(const f32x4 (&acc)[2][2][4][2], const Unit& u, int wr, int wc, int fr, int fq) const {
        const int row0 = u.pm * 256 + wr * 64 + fr, col0 = u.pn * 256 + wc * 32 + 8 * fq;
#pragma unroll
        for (int ai = 0; ai < 2; ++ai)
#pragma unroll
            for (int m = 0; m < 4; ++m) {
                const int row = row0 + ai * 128 + m * 16;
                float* yr = Y + (size_t)row * DM + col0;
                float s = 0.f;
#pragma unroll
                for (int bj = 0; bj < 2; ++bj) {
                    const f32x4 v0 = acc[ai][bj][m][0] + *(const f32x4*)(yr + bj * 128), v1 = acc[ai][bj][m][1] + *(const f32x4*)(yr + bj * 128 + 4);
                    *(f32x4*)(yr + bj * 128) = v0; *(f32x4*)(yr + bj * 128 + 4) = v1;
                    s += (v0[0] * v0[0] + v0[1] * v0[1]) + (v0[2] * v0[2] + v0[3] * v0[3]) + (v1[0] * v1[0] + v1[1] * v1[1]) + (v1[2] * v1[2] + v1[3] * v1[3]);
                }
                s += __shfl_xor(s, 16); s += __shfl_xor(s, 32);
                if (fq == 0) atomicAdd(ssq + row, s);
            }
    }
};

__device__ __forceinline__ void p0_transpose_item(const float* W, int K, int N, bf16* WT, int wt_row, LAS float* scr, int k0, int n0, int lane, const float* kscale, const float* nscale) {
#pragma unroll 8
    for (int i = 0; i < 32; ++i) { const int kk = 2 * i + (lane >> 5); float v = W[(size_t)(k0 + kk) * N + n0 + (lane & 31)]; if (kscale) v *= kscale[k0 + kk]; scr[kk * 33 + (lane & 31)] = v; }
    LDS_WAIT(); asm volatile("" ::: "memory");
    const int c = lane & 7;
#pragma unroll
    for (int j = 0; j < 4; ++j) { const int n = (lane >> 3) + 8 * j; const LAS float* s = scr + (8 * c) * 33 + n; const float ns = nscale ? nscale[n0 + n] : 1.0f;
        v4u o; o.x = pk2(s[0 * 33] * ns, s[1 * 33] * ns); o.y = pk2(s[2 * 33] * ns, s[3 * 33] * ns); o.z = pk2(s[4 * 33] * ns, s[5 * 33] * ns); o.w = pk2(s[6 * 33] * ns, s[7 * 33] * ns);
        *(v4u*)(WT + (size_t)(wt_row + n) * K + k0 + 8 * c) = o; }
    LDS_WAIT(); asm volatile("" ::: "memory");
}
__device__ __forceinline__ void rms_row_to_bf16(const float* xrow, const float* g, bf16* orow, int lane) {
    const f32x4* xr = (const f32x4*)xrow + lane; const f32x4* gr = (const f32x4*)g + lane;
    f32x4 v[8]; float s = 0.f;
#pragma unroll
    for (int j = 0; j < 8; ++j) { v[j] = xr[64 * j]; s += (v[j][0] * v[j][0] + v[j][1] * v[j][1]) + (v[j][2] * v[j][2] + v[j][3] * v[j][3]); }
    const float rstd = 1.0f / sqrtf(wave_sum(s) * (1.0f / DM) + EPS);
    v2u* o8 = (v2u*)orow + lane;
#pragma unroll
    for (int j = 0; j < 8; ++j) { const f32x4 gg = gr[64 * j]; v2u w; w.x = pk2(v[j][0] * rstd * gg[0], v[j][1] * rstd * gg[1]); w.y = pk2(v[j][2] * rstd * gg[2], v[j][3] * rstd * gg[3]); o8[64 * j] = w; }
}
__device__ __forceinline__ int win_row_of_col(int c) {
    return c < CCONV ? 256 * (c >> 7) + (c & 127) : (c < 2 * CCONV ? 256 * ((c - CCONV) >> 7) + 128 + ((c - CCONV) & 127) : c);
}

struct Args { const float* in[18]; float* out; unsigned char* ws; int ph_lo, ph_hi; };

__device__ __forceinline__ void p0_prologue(const Args& A, LAS unsigned char* lds, int gw, int NGW, int wave, int lane) {
    unsigned char* ws = A.ws;
    LAS float* scr = (LAS float*)(lds + RING_OFF + wave * 16384);
    constexpr int I_IN = (DM / 64) * (NIN / 32), I_OUT = (DM / 64) * (DM / 32), I_UP = (DM / 64) * (DFF / 32), I_DN = (DFF / 64) * (DM / 32), I_PL = 4 * (256 / 64) * (256 / 32);
    constexpr int NITEMS = I_IN + I_OUT + I_UP + I_DN + I_PL;
    for (int it = gw; it < NITEMS; it += NGW) {
        int r = it;
        if (r < I_IN) { const int nblk = NIN / 32, kb = r / nblk, nb = r % nblk; p0_transpose_item(A.in[6], DM, NIN, (bf16*)(ws + WS_WIN), win_row_of_col(32 * nb), scr, 64 * kb, 32 * nb, lane, nullptr, nullptr); continue; } r -= I_IN;
        if (r < I_OUT) { const int nblk = DM / 32, kb = r / nblk, nb = r % nblk; p0_transpose_item(A.in[13], DM, DM, (bf16*)(ws + WS_WOUT), 32 * nb, scr, 64 * kb, 32 * nb, lane, nullptr, nullptr); continue; } r -= I_OUT;
        if (r < I_UP) { const int nblk = DFF / 32, kb = r / nblk, nb = r % nblk; p0_transpose_item(A.in[15], DM, DFF, (bf16*)(ws + WS_WUP), 32 * nb, scr, 64 * kb, 32 * nb, lane, A.in[14], nullptr); continue; } r -= I_UP;
        if (r < I_DN) { const int nblk = DM / 32, kb = r / nblk, nb = r % nblk; p0_transpose_item(A.in[16], DFF, DM, (bf16*)(ws + WS_WDN), 32 * nb, scr, 64 * kb, 32 * nb, lane, nullptr, nullptr); continue; } r -= I_DN;
        { const int g = r >> 5, q = r & 31, kb = q >> 3, nb = q & 7;
          p0_transpose_item(A.in[11] + (size_t)g * 65536, 256, 256, (bf16*)(ws + WS_WPOOL) + (size_t)g * 65536, 32 * nb, scr, 64 * kb, 32 * nb, lane, nullptr, A.in[12] + g * 256); }
    }
    bf16* H = (bf16*)(ws + WS_H);
    for (int m = gw; m < HROWS; m += NGW) {
        const float* xr = m < MPROMPT ? A.in[0] + (size_t)m * DM : (m < MROWS ? A.in[1] + (size_t)(m - MPROMPT) * DM : A.in[4] + (size_t)(m - MROWS) * DM);
        rms_row_to_bf16(xr, A.in[5], H + (size_t)m * DM, lane);
    }
}

__device__ __forceinline__ void p1_meta(const Args& A, int task, int lane) {
    const bf16* H = (const bf16*)(A.ws + WS_H); const bf16* WT = (const bf16*)(A.ws + WS_WIN);
    bf16* U = (bf16*)(A.ws + WS_U); bf16* XB = (bf16*)(A.ws + WS_XB);
    const int fr = lane & 15, fq = lane >> 4;
    const bf16* ap = H + (size_t)(MROWS + fr) * DM + fq * 8;
    if (task < 64) {
        const int pn = task >> 3, j = task & 7;
        const bf16* bp = WT + (size_t)(256 * pn + 16 * j + fr) * DM + fq * 8;
        f32x4 ca = {0.f, 0.f, 0.f, 0.f}, cg = {0.f, 0.f, 0.f, 0.f};
#pragma unroll 4
        for (int kk = 0; kk < DM / 32; ++kk) {
            const bf16x8 a = *(const bf16x8*)(ap + kk * 32), ba = *(const bf16x8*)(bp + kk * 32), bg = *(const bf16x8*)(bp + (size_t)128 * DM + kk * 32);
            ca = __builtin_amdgcn_mfma_f32_16x16x32_bf16(ba, a, ca, 0, 0, 0); cg = __builtin_amdgcn_mfma_f32_16x16x32_bf16(bg, a, cg, 0, 0, 0);
        }
        v2u w; w.x = pk2(ca[0] * sigmoidf_fast(cg[0]), ca[1] * sigmoidf_fast(cg[1])); w.y = pk2(ca[2] * sigmoidf_fast(cg[2]), ca[3] * sigmoidf_fast(cg[3]));
        *(v2u*)(U + (size_t)(MROWS + fr) * CCONV + 128 * pn + 16 * j + 4 * fq) = w;
    } else {
        const int t = task - 64;
        const bf16* bp = WT + (size_t)(2 * CCONV + 16 * t + fr) * DM + fq * 8;
        f32x4 cx = {0.f, 0.f, 0.f, 0.f};
#pragma unroll 4
        for (int kk = 0; kk < DM / 32; ++kk) {
            const bf16x8 a = *(const bf16x8*)(ap + kk * 32), bx = *(const bf16x8*)(bp + kk * 32);
            cx = __builtin_amdgcn_mfma_f32_16x16x32_bf16(bx, a, cx, 0, 0, 0);
        }
        v2u w; w.x = pk2(cx[0], cx[1]); w.y = pk2(cx[2], cx[3]);
        *(v2u*)(XB + (size_t)(MROWS + fr) * CPOOL + 16 * t + 4 * fq) = w;
    }
}

template <int CTRL> __device__ __forceinline__ float dpp_mov(float v) { return __builtin_bit_cast(float, __builtin_amdgcn_update_dpp(0, __builtin_bit_cast(int, v), CTRL, 0xF, 0xF, true)); }
__device__ __forceinline__ float wave_sum_fast(float v) {
    v += dpp_mov<0xB1>(v); v += dpp_mov<0x4E>(v); v += dpp_mov<0x141>(v); v += dpp_mov<0x140>(v);
    const int iv = __builtin_bit_cast(int, v);
    return (__builtin_bit_cast(float, __builtin_amdgcn_readlane(iv, 0)) + __builtin_bit_cast(float, __builtin_amdgcn_readlane(iv, 16))) +
           (__builtin_bit_cast(float, __builtin_amdgcn_readlane(iv, 32)) + __builtin_bit_cast(float, __builtin_amdgcn_readlane(iv, 48)));
}
__device__ __forceinline__ f32x2 unpk(unsigned v) { f32x2 r; r[0] = bflo(v); r[1] = bfhi(v); return r; }
__device__ __forceinline__ unsigned ln_silu_pk(const f32x2 a, const f32x2 lg, const f32x2 lb) {
    const float mu = wave_sum_fast(a[0] + a[1]) * (1.0f / 128.0f);
    const float d0 = a[0] - mu, d1 = a[1] - mu;
    const float var = wave_sum_fast(d0 * d0 + d1 * d1) * (1.0f / 128.0f);
    const float rstd = 1.0f / sqrtf(var + EPS);
    const float y0 = d0 * rstd * lg[0] + lb[0], y1 = d1 * rstd * lg[1] + lb[1];
    return pk2(y0 * sigmoidf_fast(y0), y1 * sigmoidf_fast(y1));
}
__device__ __forceinline__ int urow_of_pos(int q, int bb) { return q < NMETA ? MROWS + (q < 0 ? 0 : q) : bb * SEQ + q - NMETA; }
constexpr int DSTRIDE = 2 * CPOOL + 16;
__device__ __forceinline__ void p2_mixer(const Args& A, LAS unsigned char* lds, int chunk, int tid, int wave, int lane) {
    const bf16* U = (const bf16*)(A.ws + WS_U); const bf16* XB = (const bf16*)(A.ws + WS_XB); bf16* CP = (bf16*)(A.ws + WS_CP);
    const int bb = chunk >> 6, s0 = (chunk & 63) * 32, nseq = chunk >> 1, t0 = (chunk & 1) * 2;
    const bool last_chunk = (chunk & 63) == 63;
    {
        const int ch = wave * 128 + 2 * lane;
        f32x2 w[CONVW];
#pragma unroll
        for (int j = 0; j < CONVW; ++j) w[j] = *(const f32x2*)(A.in[7] + j * CCONV + ch);
        const f32x2 bd = *(const f32x2*)(A.in[8] + ch), lg = *(const f32x2*)(A.in[9] + ch), lb = *(const f32x2*)(A.in[10] + ch);
        const bf16* Uc = U + ch;
        f32x2 win[30];
#pragma unroll
        for (int j = 0; j < 30; ++j) win[j] = (f32x2){0.f, 0.f};
        const int q0 = s0 - 14;
        unsigned nxt = *(const unsigned*)(Uc + (size_t)urow_of_pos(q0, bb) * CCONV);
        float* ncp = A.out + OUT_NCP + (size_t)bb * 30 * CCONV + ch;
#pragma unroll 1
        for (int it = 0; it < 62; ++it) {
            const int q = q0 + it;
            const unsigned cur = q < 0 ? 0u : nxt;
            if (it + 1 < 62) nxt = *(const unsigned*)(Uc + (size_t)urow_of_pos(q + 1, bb) * CCONV);
            const f32x2 nv = unpk(cur);
            if (it >= 30) {
                f32x2 acc = bd;
#pragma unroll
                for (int j = 0; j < 30; ++j) acc = __builtin_elementwise_fma(w[j], win[j], acc);
                acc = __builtin_elementwise_fma(w[30], nv, acc);
                *(unsigned*)(CP + (size_t)(bb * SEQ + s0 + it - 30) * DM + ch) = ln_silu_pk(acc, lg, lb);
            }
            if (last_chunk && it >= 32) *(f32x2*)(ncp + (size_t)(it - 32) * CCONV) = nv;
#pragma unroll
            for (int j = 0; j < 29; ++j) win[j] = win[j + 1];
            win[29] = nv;
        }
#pragma unroll
        for (int j = 0; j < 30; ++j) win[j] = (f32x2){0.f, 0.f};
        float* ncs = A.out + OUT_NCS + (size_t)nseq * 30 * CCONV + ch;
#pragma unroll 1
        for (int k = 0; k < 32; ++k) {
            const int idx = t0 + k;
            f32x2 nv;
            if (idx < 30) nv = *(const f32x2*)(A.in[2] + ((size_t)nseq * 30 + idx) * CCONV + ch);
            else nv = unpk(*(const unsigned*)(Uc + (size_t)(MPROMPT + nseq * DECS + idx - 30) * CCONV));
            if (k >= 30) {
                f32x2 acc = bd;
#pragma unroll
                for (int j = 0; j < 30; ++j) acc = __builtin_elementwise_fma(w[j], win[j], acc);
                acc = __builtin_elementwise_fma(w[30], nv, acc);
                *(unsigned*)(CP + (size_t)(MPROMPT + nseq * DECS + t0 + k - 30) * DM + ch) = ln_silu_pk(acc, lg, lb);
            }
            if (t0 == 2 && idx >= 4) *(f32x2*)(ncs + (size_t)(idx - 4) * CCONV) = nv;
#pragma unroll
            for (int j = 0; j < 29; ++j) win[j] = win[j + 1];
            win[29] = nv;
        }
    }
    {
        const int pc = 2 * tid, gi = wave >> 1; const float inv_w = 1.0f / (float)(2 << gi);
        const bf16* Xc = XB + pc;
        f32x2 pw[16];
#pragma unroll
        for (int j = 0; j < 16; ++j) pw[j] = (f32x2){0.f, 0.f};
        float* npp = A.out + OUT_NPP + (size_t)bb * 15 * CPOOL + pc;
        unsigned nxt = *(const unsigned*)(Xc + (size_t)urow_of_pos(s0 + 1, bb) * CPOOL);
#pragma unroll 1
        for (int it = 0; it < 47; ++it) {
            const unsigned cur = nxt;
            if (it + 1 < 47) nxt = *(const unsigned*)(Xc + (size_t)urow_of_pos(s0 + 2 + it, bb) * CPOOL);
            const f32x2 nv = unpk(cur);
#pragma unroll
            for (int j = 0; j < 15; ++j) pw[j] = pw[j + 1];
            pw[15] = nv;
            if (it >= 15) {
                f32x2 s = pw[15] + pw[14];
                if (gi >= 1) s += pw[13] + pw[12];
                if (gi >= 2) s += (pw[11] + pw[10]) + (pw[9] + pw[8]);
                if (gi >= 3) s += ((pw[7] + pw[6]) + (pw[5] + pw[4])) + ((pw[3] + pw[2]) + (pw[1] + pw[0]));
                const f32x2 d = s * inv_w - nv;
                *(LAS unsigned*)(lds + RING_OFF + (it - 15) * DSTRIDE + pc * 2) = pk2(d[0], d[1]);
            }
            if (last_chunk && it >= 32) *(f32x2*)(npp + (size_t)(it - 32) * CPOOL) = nv;
        }
#pragma unroll
        for (int j = 0; j < 16; ++j) pw[j] = (f32x2){0.f, 0.f};
        float* nps = A.out + OUT_NPS + (size_t)nseq * 15 * CPOOL + pc;
#pragma unroll 1
        for (int m = 0; m < 17; ++m) {
            const int idx = t0 + m;
            f32x2 nv;
            if (idx < 15) nv = *(const f32x2*)(A.in[3] + ((size_t)nseq * 15 + idx) * CPOOL + pc);
            else nv = unpk(*(const unsigned*)(Xc + (size_t)(MPROMPT + nseq * DECS + idx - 15) * CPOOL));
#pragma unroll
            for (int j = 0; j < 15; ++j) pw[j] = pw[j + 1];
            pw[15] = nv;
            if (m >= 15) {
                f32x2 s = pw[15] + pw[14];
                if (gi >= 1) s += pw[13] + pw[12];
                if (gi >= 2) s += (pw[11] + pw[10]) + (pw[9] + pw[8]);
                if (gi >= 3) s += ((pw[7] + pw[6]) + (pw[5] + pw[4])) + ((pw[3] + pw[2]) + (pw[1] + pw[0]));
                const f32x2 d = s * inv_w - nv;
                *(LAS unsigned*)(lds + RING_OFF + (32 + m - 15) * DSTRIDE + pc * 2) = pk2(d[0], d[1]);
            }
            if (t0 == 2 && idx >= 4) *(f32x2*)(nps + (size_t)(idx - 4) * CPOOL) = nv;
        }
    }
    LDS_WAIT(); __syncthreads();
    {
        const int g = wave >> 1, dh = wave & 1, fr = lane & 15, fq = lane >> 4;
        const bf16* Wp = (const bf16*)(A.ws + WS_WPOOL) + (size_t)g * 65536 + (size_t)(dh * 128 + fr) * 256 + fq * 8;
        f32x4 pacc[3][8];
#pragma unroll
        for (int mt = 0; mt < 3; ++mt)
#pragma unroll
            for (int nt = 0; nt < 8; ++nt) pacc[mt][nt] = (f32x4){0.f, 0.f, 0.f, 0.f};
#pragma unroll 2
        for (int kk = 0; kk < 8; ++kk) {
            bf16x8 a[3];
#pragma unroll
            for (int mt = 0; mt < 3; ++mt) a[mt] = *(const LAS bf16x8*)(lds + RING_OFF + (mt * 16 + fr) * DSTRIDE + (g * 256 + kk * 32 + fq * 8) * 2);
#pragma unroll
            for (int nt = 0; nt < 8; ++nt) { const bf16x8 b = *(const bf16x8*)(Wp + (size_t)nt * 16 * 256 + kk * 32);
#pragma unroll
                for (int mt = 0; mt < 3; ++mt) pacc[mt][nt] = __builtin_amdgcn_mfma_f32_16x16x32_bf16(b, a[mt], pacc[mt][nt], 0, 0, 0); }
        }
#pragma unroll
        for (int mt = 0; mt < 3; ++mt) {
            const int rl = mt * 16 + fr;
            const int grow = rl < 32 ? bb * SEQ + s0 + rl : MPROMPT + nseq * DECS + t0 + (rl - 32);
            if (rl < 34) {
                bf16* o = CP + (size_t)grow * DM + CCONV + g * 256 + dh * 128 + 4 * fq;
#pragma unroll
                for (int nt = 0; nt < 8; ++nt) { v2u wv; wv.x = cvt_pk_bf16(pacc[mt][nt][0], pacc[mt][nt][1]); wv.y = cvt_pk_bf16(pacc[mt][nt][2], pacc[mt][nt][3]); *(v2u*)(o + nt * 16) = wv; }
            }
        }
    }
    __syncthreads();
}

#ifndef MK_N_LAUNCHES
#define MK_N_LAUNCHES 1
#endif
constexpr int N_PHASES = 7;
__global__ void __launch_bounds__(512, 2) mk_fwd(Args args) {
    extern __shared__ __attribute__((aligned(16))) unsigned char lds_raw[];
    LAS unsigned char* lds = (LAS unsigned char*)lds_raw;
    const int tid = threadIdx.x, lane = tid & 63, wave = __builtin_amdgcn_readfirstlane(tid >> 6);
    const int G = gridDim.x, bx = blockIdx.x;
    const int vcu = (G % 8 == 0) ? (bx % 8) * (G / 8) + bx / 8 : bx;
    unsigned char* ws = args.ws;
    unsigned* ctl = (unsigned*)(ws + WS_CTL);
    volatile LAS unsigned* MISC = (volatile LAS unsigned*)(lds + LDSCTL_OFF);
    if (tid < 64) MISC[tid] = 0u;
    __syncthreads();
    XcdBarrier bar; bar.bar = ctl + CW_BAR; bar.x = 0; bar.st = nullptr;
    if (MK_N_LAUNCHES == 1) bar = xcd_barrier_post(ctl + CW_BAR, MISC + 8);
    const int lo = args.ph_lo, hi = args.ph_hi;
#define IN(k) (lo <= (k) && (k) < hi)
#define BOTH(k) (IN(k) && IN((k) + 1))
#define GRID_BAR() do { if (MK_N_LAUNCHES == 1) xcd_barrier(bar); } while (0)
    float* ssq1 = (float*)(ctl + CW_SSQ1); float* ssq2 = (float*)(ctl + CW_SSQ2);
    float* Y = args.out + OUT_Y;

    if (IN(0)) { p0_prologue(args, lds, vcu * 8 + wave, G * 8, wave, lane); VM_WAIT(); __syncthreads(); if (BOTH(0)) GRID_BAR(); }

    if (IN(1)) {
        pg8::Gemm g{(const bf16*)(ws + WS_H), (const bf16*)(ws + WS_WIN), MROWS, NIN, DM}; pg8::StaticOrder S; S.init(MROWS, NIN, G, bx);
        EpiIn E{(bf16*)(ws + WS_U), (bf16*)(ws + WS_XB)};
        pg8::gemm_phase<EpiIn, pg8::StaticOrder, true, true>(lds + RING_OFF, g, S, E);
        const int task = (G - 1 - bx) * 8 + wave;
        if (task < 128) p1_meta(args, task, lane);
        if (BOTH(1)) GRID_BAR();
    }

    if (IN(2)) {
        for (int chunk = bx; chunk < 256; chunk += G) p2_mixer(args, lds, chunk, tid, wave, lane);
        if (BOTH(2)) GRID_BAR();
    }

    if (IN(3)) {
        pg8::Gemm g{(const bf16*)(ws + WS_CP), (const bf16*)(ws + WS_WOUT), MROWS, DM, DM}; pg8::StaticOrder S; S.init(MROWS, DM, G, bx);
        EpiOut E{args.in[0], args.in[1], Y, (bf16*)(ws + WS_X1B), ssq1};
        pg8::gemm_phase<EpiOut, pg8::StaticOrder, true, true>(lds + RING_OFF, g, S, E);
        if (BOTH(3)) GRID_BAR();
    }

    if (IN(4)) {
        pg8::Gemm g{(const bf16*)(ws + WS_X1B), (const bf16*)(ws + WS_WUP), MROWS, DFF, DM}; pg8::StaticOrder S; S.init(MROWS, DFF, G, bx);
        EpiUp E{(bf16*)(ws + WS_ACT), ssq1};
        pg8::gemm_phase<EpiUp, pg8::StaticOrder, true, true>(lds + RING_OFF, g, S, E);
        if (BOTH(4)) GRID_BAR();
    }

    if (IN(5)) {
        pg8::Gemm g{(const bf16*)(ws + WS_ACT), (const bf16*)(ws + WS_WDN), MROWS, DM, DFF}; pg8::StaticOrder S; S.init(MROWS, DM, G, bx);
        EpiDown E{Y, ssq2};
        pg8::gemm_phase<EpiDown, pg8::StaticOrder, true, true>(lds + RING_OFF, g, S, E);
        if (BOTH(5)) GRID_BAR();
    }

    if (IN(6)) {
        const f32x4* gr = (const f32x4*)args.in[17] + lane;
        for (int m = vcu * 8 + wave; m < MROWS; m += G * 8) {
            const float rstd = 1.0f / sqrtf(__builtin_nontemporal_load(ssq2 + m) * (1.0f / DM) + EPS);
            f32x4* yr = (f32x4*)(Y + (size_t)m * DM) + lane;
#pragma unroll
            for (int j = 0; j < 8; ++j) { const f32x4 gg = gr[64 * j]; f32x4 v = yr[64 * j]; v = v * rstd * gg; yr[64 * j] = v; }
        }
    }
#undef IN
#undef BOTH
#undef GRID_BAR
}

extern "C" void kernel_launch(void* const* d_in, const int* in_sizes, int n_in, void* d_out, int out_size, void* d_ws, size_t ws_size, hipStream_t stream) {
    static int grid = 0;
    if (grid == 0) {
        if (n_in != 18 || (size_t)out_size != OUT_END || ws_size < WS_END) { fprintf(stderr, "kernel_launch: unexpected shapes (n_in %d, out %d, ws %zu); nothing launched\n", n_in, out_size, ws_size); grid = -1; return; }
        int dev = 0, cus = 0;
        if (hipGetDevice(&dev) != hipSuccess || hipDeviceGetAttribute(&cus, hipDeviceAttributeMultiprocessorCount, dev) != hipSuccess) { grid = -1; return; }
        if (hipFuncSetAttribute((const void*)mk_fwd, hipFuncAttributeMaxDynamicSharedMemorySize, LDS_BYTES) != hipSuccess) { fprintf(stderr, "kernel_launch: hipFuncSetAttribute failed\n"); grid = -1; return; }
        int per_cu = 0;
        if (hipOccupancyMaxActiveBlocksPerMultiprocessor(&per_cu, (const void*)mk_fwd, 512, LDS_BYTES) != hipSuccess || per_cu < 1) fprintf(stderr, "kernel_launch: occupancy query says %d per CU\n", per_cu);
        (void)hipGetLastError();
        grid = cus;
    }
    if (grid < 0) return;
    if (hipMemsetAsync((char*)d_ws + WS_CTL, 0, CTL_ZERO_BYTES, stream) != hipSuccess) return;
    Args a{};
    for (int i = 0; i < 18; ++i) a.in[i] = (const float*)d_in[i];
    a.out = (float*)d_out; a.ws = (unsigned char*)d_ws;
    if (MK_N_LAUNCHES == 1) {
        a.ph_lo = 0; a.ph_hi = N_PHASES;
        hipLaunchKernelGGL(mk_fwd, dim3(grid), dim3(512), LDS_BYTES, stream, a);
    } else {
        for (int p = 0; p < N_PHASES; ++p) { a.ph_lo = p; a.ph_hi = p + 1; hipLaunchKernelGGL(mk_fwd, dim3(grid), dim3(512), LDS_BYTES, stream, a); }
    }
}
```
